# Optimizing an MI355X kernel written in HIP

```python
import jax
import jax.numpy as jnp
from jax import lax
import numpy as np

D_MODEL = 1024
BATCH = 8
SEQ = 4096
DEPTH = 1

PLE_DIM = 256
D_FF = 2816
RET_HEADS = 4
RET_QK_DIM = 64
RET_V_DIM = 128
RET_CHUNK = 128
SWA_Q_HEADS = 8
SWA_KV_HEADS = 2
SWA_HEAD_DIM = 64
SWA_WINDOW = 128
ROPE_BASE = 10000.0
EPS = 1e-6
NEG_INF = -1e30

RET_QK_W = RET_HEADS * RET_QK_DIM
RET_V_W = RET_HEADS * RET_V_DIM
SWA_Q_W = SWA_Q_HEADS * SWA_HEAD_DIM
SWA_KV_W = SWA_KV_HEADS * SWA_HEAD_DIM
MIX_W = RET_V_W + SWA_Q_W
IN_W = 2 * RET_QK_W + 2 * RET_V_W + SWA_Q_W + 2 * SWA_KV_W
SPLIT_POINTS = (
    RET_QK_W,
    2 * RET_QK_W,
    2 * RET_QK_W + RET_V_W,
    2 * RET_QK_W + 2 * RET_V_W,
    2 * RET_QK_W + 2 * RET_V_W + SWA_Q_W,
    2 * RET_QK_W + 2 * RET_V_W + SWA_Q_W + SWA_KV_W,
)

kernel_name = 'hymba_style_retention_swa_sink_macaron'


def _rmsnorm(x, g):
    x32 = x.astype(jnp.float32)
    y = x32 * lax.rsqrt(jnp.mean(x32 * x32, axis=-1, keepdims=True) + EPS)
    return y.astype(x.dtype) * g


def _swiglu(x, w_gate, w_up, w_down):
    return (jax.nn.silu(x @ w_gate) * (x @ w_up)) @ w_down


def _rotary(x, pos):
    half = x.shape[-1] // 2
    inv_freq = ROPE_BASE ** (-jnp.arange(half, dtype=jnp.float32) / half)
    ang = pos.astype(jnp.float32)[:, :, None, None] * inv_freq
    cos, sin = jnp.cos(ang), jnp.sin(ang)
    x32 = x.astype(jnp.float32)
    x1, x2 = x32[..., :half], x32[..., half:]
    return jnp.concatenate([x1 * cos - x2 * sin, x2 * cos + x1 * sin], axis=-1).astype(x.dtype)


def _head_groupnorm(y):
    y32 = y.astype(jnp.float32)
    mu = jnp.mean(y32, axis=-1, keepdims=True)
    var = jnp.mean(jnp.square(y32 - mu), axis=-1, keepdims=True)
    return ((y32 - mu) * lax.rsqrt(var + EPS)).astype(y.dtype)


def _retention_chunkwise(q, k, v):
    B, S, H, dk = q.shape
    dv = v.shape[-1]
    C = RET_CHUNK
    N = S // C
    log_gamma = jnp.log(1.0 - 2.0 ** (-5.0 - jnp.arange(H, dtype=jnp.float32)))
    idx = jnp.arange(C, dtype=jnp.float32)
    diff = idx[:, None] - idx[None, :]
    causal = diff >= 0
    decay_intra = jnp.where(causal[None], jnp.exp(log_gamma[:, None, None] * jnp.where(causal, diff, 0.0)[None]), 0.0)
    q_decay = jnp.exp(log_gamma[:, None] * (idx[None, :] + 1.0))
    k_decay = jnp.exp(log_gamma[:, None] * (C - 1.0 - idx[None, :]))
    chunk_decay = jnp.exp(log_gamma * C)

    qc = q.astype(jnp.float32).reshape(B, N, C, H, dk)
    kc = k.astype(jnp.float32).reshape(B, N, C, H, dk) * (dk ** -0.5)
    vc = v.astype(jnp.float32).reshape(B, N, C, H, dv)

    scores = jnp.einsum('bnchd,bnmhd->bnhcm', qc, kc) * decay_intra
    intra = jnp.einsum('bnhcm,bnmhe->bnche', scores, vc)
    kv = jnp.einsum('bnmhd,hm,bnmhe->bnhde', kc, k_decay, vc)

    def step(state, kv_n):
        return chunk_decay[:, None, None] * state + kv_n, state

    init = jnp.zeros((B, H, dk, dv), jnp.float32)
    _, state_prev = lax.scan(step, init, jnp.moveaxis(kv, 1, 0))
    state_prev = jnp.moveaxis(state_prev, 0, 1)
    cross = jnp.einsum('bnchd,hc,bnhde->bnche', qc, q_decay, state_prev)
    return (intra + cross).reshape(B, S, H, dv).astype(v.dtype)


def _swa_with_sinks(q, k, v, sinks):
    B, S, Hq, D = q.shape
    Hkv = k.shape[2]
    G = Hq // Hkv
    W = SWA_WINDOW
    N = S // W
    qb = q.reshape(B, N, W, Hkv, G, D)
    pad = ((0, 0), (1, 0), (0, 0), (0, 0), (0, 0))
    kp = jnp.pad(k.reshape(B, N, W, Hkv, D), pad)
    vp = jnp.pad(v.reshape(B, N, W, Hkv, D), pad)
    kwin = jnp.concatenate([kp[:, :-1], kp[:, 1:]], axis=2)
    vwin = jnp.concatenate([vp[:, :-1], vp[:, 1:]], axis=2)

    scores = jnp.einsum('bnqhgd,bnkhd->bnhgqk', qb, kwin).astype(jnp.float32) * (D ** -0.5)
    qi = jnp.arange(W)[:, None] + W
    kj = jnp.arange(2 * W)[None, :]
    rel = qi - kj
    valid = (rel >= 0) & (rel < W)
    blk_valid = valid[None] & ((jnp.arange(N)[:, None, None] > 0) | (kj >= W)[None])
    scores = jnp.where(blk_valid[None, :, None, None], scores, NEG_INF)

    sink = sinks.astype(jnp.float32).reshape(Hkv, G)[None, None, :, :, None, None]
    m = jnp.maximum(jnp.max(scores, axis=-1, keepdims=True), sink)
    e = jnp.exp(scores - m)
    denom = jnp.sum(e, axis=-1, keepdims=True) + jnp.exp(sink - m)
    probs = (e / denom).astype(v.dtype)
    out = jnp.einsum('bnhgqk,bnkhd->bnqhgd', probs, vwin)
    return out.reshape(B, S, Hq * D)


def setup_inputs(seed: int = 0) -> dict:
    key = jax.random.key(seed)
    ks = jax.random.split(key, 24)
    f32 = jnp.float32

    def w(k, shape, fan_in):
        return jax.random.normal(k, shape, f32) * (fan_in ** -0.5)

    def gain(k):
        return 1.0 + 0.02 * jax.random.normal(k, (DEPTH, D_MODEL), f32)

    x = jax.random.normal(ks[0], (BATCH, SEQ, D_MODEL), f32)
    p = jax.random.normal(ks[1], (DEPTH, BATCH, SEQ, PLE_DIM), f32)
    positions = jnp.tile(jnp.arange(SEQ, dtype=jnp.int32)[None, :], (BATCH, 1))
    return {
        'x': x,
        'p': p,
        'positions': positions,
        'ffn1_pre_g': gain(ks[2]),
        'ffn1_post_g': gain(ks[3]),
        'ffn1_w_gate': w(ks[4], (DEPTH, D_MODEL, D_FF), D_MODEL),
        'ffn1_w_up': w(ks[5], (DEPTH, D_MODEL, D_FF), D_MODEL),
        'ffn1_w_down': w(ks[6], (DEPTH, D_FF, D_MODEL), D_FF),
        'mix_pre_g': gain(ks[7]),
        'mix_post_g': gain(ks[8]),
        'w_in': w(ks[9], (DEPTH, D_MODEL, IN_W), D_MODEL),
        'b_in': 0.02 * jax.random.normal(ks[10], (DEPTH, IN_W), f32),
        'swa_sinks': 0.5 * jax.random.normal(ks[11], (DEPTH, SWA_Q_HEADS), f32),
        'w_out': w(ks[12], (DEPTH, MIX_W, D_MODEL), MIX_W),
        'ffn2_pre_g': gain(ks[13]),
        'ffn2_post_g': gain(ks[14]),
        'ffn2_w_gate': w(ks[15], (DEPTH, D_MODEL, D_FF), D_MODEL),
        'ffn2_w_up': w(ks[16], (DEPTH, D_MODEL, D_FF), D_MODEL),
        'ffn2_w_down': w(ks[17], (DEPTH, D_FF, D_MODEL), D_FF),
        'ple_w_proj': w(ks[18], (DEPTH, PLE_DIM, D_MODEL), PLE_DIM),
        'ple_w_gate': w(ks[19], (DEPTH, D_MODEL, D_MODEL), D_MODEL),
        'ple_norm_g': gain(ks[20]),
    }


def reference(x, p, positions, ffn1_pre_g, ffn1_post_g, ffn1_w_gate, ffn1_w_up, ffn1_w_down,
              mix_pre_g, mix_post_g, w_in, b_in, swa_sinks, w_out,
              ffn2_pre_g, ffn2_post_g, ffn2_w_gate, ffn2_w_up, ffn2_w_down,
              ple_w_proj, ple_w_gate, ple_norm_g):
    B, S, _ = x.shape
    h = x
    for i in range(DEPTH):
        a = _rmsnorm(h, ffn1_pre_g[i])
        h = h + 0.5 * _rmsnorm(_swiglu(a, ffn1_w_gate[i], ffn1_w_up[i], ffn1_w_down[i]), ffn1_post_g[i])

        u = _rmsnorm(h, mix_pre_g[i])
        z = u @ w_in[i] + b_in[i]
        rq, rk, rv, rg, sq, sk, sv = jnp.split(z, SPLIT_POINTS, axis=-1)

        rq = _rotary(rq.reshape(B, S, RET_HEADS, RET_QK_DIM), positions)
        rk = _rotary(rk.reshape(B, S, RET_HEADS, RET_QK_DIM), positions)
        rv = rv.reshape(B, S, RET_HEADS, RET_V_DIM)
        ret = _head_groupnorm(_retention_chunkwise(rq, rk, rv)).reshape(B, S, RET_V_W)
        ret = jax.nn.silu(rg) * ret

        swa = _swa_with_sinks(sq.reshape(B, S, SWA_Q_HEADS, SWA_HEAD_DIM),
                              sk.reshape(B, S, SWA_KV_HEADS, SWA_HEAD_DIM),
                              sv.reshape(B, S, SWA_KV_HEADS, SWA_HEAD_DIM),
                              swa_sinks[i])

        mix = jnp.concatenate([ret, swa], axis=-1) @ w_out[i]
        h = h + _rmsnorm(mix, mix_post_g[i])

        a = _rmsnorm(h, ffn2_pre_g[i])
        h = h + 0.5 * _rmsnorm(_swiglu(a, ffn2_w_gate[i], ffn2_w_up[i], ffn2_w_down[i]), ffn2_post_g[i])

        gate = jax.nn.sigmoid(h @ ple_w_gate[i])
        h = h + _rmsnorm(gate * (p[i] @ ple_w_proj[i]), ple_norm_g[i])
    return h
```

```cpp
#include <hip/hip_runtime.h>
namespace nv {
constexpr int D = 1024, S = 4096, FF = 2816, INW = 2304, PLE = 256;
constexpr float EPS = 1e-6f;

__device__ __forceinline__ float wsum(float v) {
#pragma unroll
    for (int o = 1; o < 64; o <<= 1) v += __shfl_xor(v, o);
    return v;
}
__device__ __forceinline__ float wmax(float v) {
#pragma unroll
    for (int o = 1; o < 64; o <<= 1) v = fmaxf(v, __shfl_xor(v, o));
    return v;
}
__global__ void __launch_bounds__(256) k_rmsnorm(const float* x, const float* g, const float* res, float alpha, float* out, int rows) {
    const int row = blockIdx.x * 4 + (threadIdx.x >> 6), lane = threadIdx.x & 63;
    if (row >= rows) return;
    const float* xr = x + (size_t)row * D;
    float v[16]; float s = 0.f;
#pragma unroll
    for (int j = 0; j < 16; ++j) { v[j] = xr[lane + 64 * j]; s += v[j] * v[j]; }
    s = wsum(s);
    const float r = rsqrtf(s * (1.0f / D) + EPS);
#pragma unroll
    for (int j = 0; j < 16; ++j) {
        const int c = lane + 64 * j;
        float o = alpha * (v[j] * r) * g[c];
        if (res) o += res[(size_t)row * D + c];
        out[(size_t)row * D + c] = o;
    }
}
__global__ void __launch_bounds__(256) k_gemm(const float* A, int lda, const float* Bm, int ldb, float* C, int ldc, int K, const float* bias) {
    __shared__ float As[16][64 + 4];
    __shared__ float Bs[16][64 + 4];
    const int tid = threadIdx.x, tx = tid & 15, ty = tid >> 4;
    const int m0 = blockIdx.y * 64, n0 = blockIdx.x * 64;
    float acc[4][4];
#pragma unroll
    for (int i = 0; i < 4; ++i)
#pragma unroll
        for (int j = 0; j < 4; ++j) acc[i][j] = 0.f;
    for (int k0 = 0; k0 < K; k0 += 16) {
        {
            const int r = tid >> 2, c = (tid & 3) * 4;
            const float4 a = *(const float4*)(A + (size_t)(m0 + r) * lda + k0 + c);
            As[c + 0][r] = a.x; As[c + 1][r] = a.y; As[c + 2][r] = a.z; As[c + 3][r] = a.w;
            const int kr = tid >> 4, nc = (tid & 15) * 4;
            const float4 b = *(const float4*)(Bm + (size_t)(k0 + kr) * ldb + n0 + nc);
            Bs[kr][nc + 0] = b.x; Bs[kr][nc + 1] = b.y; Bs[kr][nc + 2] = b.z; Bs[kr][nc + 3] = b.w;
        }
        __syncthreads();
#pragma unroll
        for (int kk = 0; kk < 16; ++kk) {
            float a[4], b[4];
#pragma unroll
            for (int i = 0; i < 4; ++i) a[i] = As[kk][ty * 4 + i];
#pragma unroll
            for (int j = 0; j < 4; ++j) b[j] = Bs[kk][tx * 4 + j];
#pragma unroll
            for (int i = 0; i < 4; ++i)
#pragma unroll
                for (int j = 0; j < 4; ++j) acc[i][j] = fmaf(a[i], b[j], acc[i][j]);
        }
        __syncthreads();
    }
#pragma unroll
    for (int i = 0; i < 4; ++i)
#pragma unroll
        for (int j = 0; j < 4; ++j) {
            const int r = m0 + ty * 4 + i, c = n0 + tx * 4 + j;
            C[(size_t)r * ldc + c] = acc[i][j] + (bias ? bias[c] : 0.f);
        }
}
__device__ __forceinline__ float silu(float v) { return v / (1.0f + expf(-v)); }
__global__ void k_swiglu(float* G, const float* U, size_t n) {
    const size_t i = (size_t)blockIdx.x * blockDim.x + threadIdx.x;
    if (i < n) G[i] = silu(G[i]) * U[i];
}
__global__ void k_rotary(float* z, const int* pos, int rows) {
    const size_t i = (size_t)blockIdx.x * blockDim.x + threadIdx.x;
    if (i >= (size_t)rows * 256) return;
    const int row = (int)(i >> 8), hh = (int)(i >> 5) & 7, d = (int)i & 31;
    const float inv_freq = powf(10000.0f, -(float)d / 32.0f);
    const float ang = (float)pos[row] * inv_freq;
    const float c = cosf(ang), s = sinf(ang);
    float* p = z + (size_t)row * INW + hh * 64 + d;
    const float x1 = p[0], x2 = p[32];
    p[0] = x1 * c - x2 * s; p[32] = x2 * c + x1 * s;
}
__global__ void __launch_bounds__(256) k_retention(const float* z, float* ret  ) {
    __shared__ float qs[64], ks[64], part[2][128];
    const int h = blockIdx.x, tid = threadIdx.x, e = tid & 127, dh = tid >> 7;
    const float gamma = 1.0f - exp2f(-5.0f - (float)h);
    float st[32];
#pragma unroll
    for (int i = 0; i < 32; ++i) st[i] = 0.f;
    for (int t = 0; t < S; ++t) {
        const float* zr = z + (size_t)t * INW;
        if (tid < 64) qs[tid] = zr[h * 64 + tid];
        else if (tid < 128) ks[tid - 64] = zr[256 + h * 64 + (tid - 64)] * 0.125f;
        const float v = zr[512 + h * 128 + e];
        __syncthreads();
        float o = 0.f;
#pragma unroll
        for (int i = 0; i < 32; ++i) { st[i] = gamma * st[i] + ks[dh * 32 + i] * v; o += qs[dh * 32 + i] * st[i]; }
        part[dh][e] = o;
        __syncthreads();
        if (tid < 128) ret[(size_t)t * 512 + h * 128 + tid] = part[0][tid] + part[1][tid];
    }
}
__global__ void __launch_bounds__(256) k_gn_gate(const float* ret, const float* z, float* mixin, int rows) {
    const int item = blockIdx.x * 4 + (threadIdx.x >> 6), lane = threadIdx.x & 63;
    if (item >= rows * 4) return;
    const int t = item >> 2, h = item & 3;
    const float a = ret[(size_t)t * 512 + h * 128 + lane], b = ret[(size_t)t * 512 + h * 128 + 64 + lane];
    const float mu = wsum(a + b) * (1.0f / 128.0f);
    const float da = a - mu, db = b - mu;
    const float var = wsum(da * da + db * db) * (1.0f / 128.0f);
    const float r = rsqrtf(var + EPS);
    const float g0 = z[(size_t)t * INW + 1024 + h * 128 + lane], g1 = z[(size_t)t * INW + 1024 + h * 128 + 64 + lane];
    mixin[(size_t)t * D + h * 128 + lane] = silu(g0) * (da * r);
    mixin[(size_t)t * D + h * 128 + 64 + lane] = silu(g1) * (db * r);
}
__global__ void __launch_bounds__(256) k_swa(const float* z, const float* sinks, float* mixin, int rows) {
    const int item = blockIdx.x * 4 + (threadIdx.x >> 6), lane = threadIdx.x & 63;
    if (item >= rows * 8) return;
    const int t = item >> 3, hq = item & 7, hk = hq >> 2;
    const float* q = z + (size_t)t * INW + 1536 + hq * 64;
    float sc[2];
#pragma unroll
    for (int u = 0; u < 2; ++u) {
        const int j = t - 127 + lane + 64 * u;
        float s = -1e30f;
        if (j >= 0) {
            const float* k = z + (size_t)j * INW + 2048 + hk * 64;
            float a = 0.f;
            for (int d = 0; d < 64; ++d) a += q[d] * k[d];
            s = a * 0.125f;
        }
        sc[u] = s;
    }
    const float sink = sinks[hq];
    const float m = fmaxf(wmax(fmaxf(sc[0], sc[1])), sink);
    const float e0 = expf(sc[0] - m), e1 = expf(sc[1] - m);
    const float den = wsum(e0 + e1) + expf(sink - m);
    const float p0 = e0 / den, p1 = e1 / den;
    float o = 0.f;
    for (int jj = 0; jj < 128; ++jj) {
        const int j = t - 127 + jj;
        const float pj = __shfl(jj < 64 ? p0 : p1, jj & 63);
        if (j >= 0) o += pj * z[(size_t)j * INW + 2176 + hk * 64 + lane];
    }
    mixin[(size_t)t * D + 512 + hq * 64 + lane] = o;
}
__global__ void k_sigmul(float* G, const float* P, size_t n) {
    const size_t i = (size_t)blockIdx.x * blockDim.x + threadIdx.x;
    if (i < n) G[i] = P[i] / (1.0f + expf(-G[i]));
}

struct Bufs { float *A, *G, *U, *Y, *Z, *R, *MIX; };

inline void gemm(hipStream_t st, const float* A, int lda, const float* Bm, int ldb, float* C, int ldc, int Mr, int N, int K, const float* bias) {
    k_gemm<<<dim3(N / 64, Mr / 64), 256, 0, st>>>(A, lda, Bm, ldb, C, ldc, K, bias);
}
inline void forward_batch(hipStream_t st, void* const* d_in, float* out_b, int b, const Bufs& w, float* cH1, float* ch1, float* cZ, float* cMIX, float* ch2, float* ch3) {
    const float* x = (const float*)d_in[0] + (size_t)b * S * D;
    const float* p = (const float*)d_in[1] + (size_t)b * S * PLE;
    const int* pos = (const int*)d_in[2] + (size_t)b * S;
    auto F = [&](int i) { return (const float*)d_in[i]; };
    const size_t nff = (size_t)S * FF, nd = (size_t)S * D;
    k_rmsnorm<<<S / 4, 256, 0, st>>>(x, F(3), nullptr, 1.0f, w.A, S);
    gemm(st, w.A, D, F(5), FF, w.G, FF, S, FF, D, nullptr);
    gemm(st, w.A, D, F(6), FF, w.U, FF, S, FF, D, nullptr);
    k_swiglu<<<(unsigned)((nff + 255) / 256), 256, 0, st>>>(w.G, w.U, nff);
    if (cH1) hipMemcpyAsync(cH1, w.G, nff * 4, hipMemcpyDeviceToDevice, st);
    gemm(st, w.G, FF, F(7), D, w.Y, D, S, D, FF, nullptr);
    k_rmsnorm<<<S / 4, 256, 0, st>>>(w.Y, F(4), x, 0.5f, out_b, S);
    if (ch1) hipMemcpyAsync(ch1, out_b, nd * 4, hipMemcpyDeviceToDevice, st);
    k_rmsnorm<<<S / 4, 256, 0, st>>>(out_b, F(8), nullptr, 1.0f, w.A, S);
    gemm(st, w.A, D, F(10), INW, w.Z, INW, S, INW, D, F(11));
    k_rotary<<<(S * 256) / 256, 256, 0, st>>>(w.Z, pos, S);
    if (cZ) hipMemcpyAsync(cZ, w.Z, (size_t)S * INW * 4, hipMemcpyDeviceToDevice, st);
    k_retention<<<4, 256, 0, st>>>(w.Z, w.R);
    k_gn_gate<<<S, 256, 0, st>>>(w.R, w.Z, w.MIX, S);
    k_swa<<<S * 2, 256, 0, st>>>(w.Z, F(12), w.MIX, S);
    if (cMIX) hipMemcpyAsync(cMIX, w.MIX, nd * 4, hipMemcpyDeviceToDevice, st);
    gemm(st, w.MIX, D, F(13), D, w.Y, D, S, D, D, nullptr);
    k_rmsnorm<<<S / 4, 256, 0, st>>>(w.Y, F(9), out_b, 1.0f, out_b, S);
    if (ch2) hipMemcpyAsync(ch2, out_b, nd * 4, hipMemcpyDeviceToDevice, st);
    k_rmsnorm<<<S / 4, 256, 0, st>>>(out_b, F(14), nullptr, 1.0f, w.A, S);
    gemm(st, w.A, D, F(16), FF, w.G, FF, S, FF, D, nullptr);
    gemm(st, w.A, D, F(17), FF, w.U, FF, S, FF, D, nullptr);
    k_swiglu<<<(unsigned)((nff + 255) / 256), 256, 0, st>>>(w.G, w.U, nff);
    gemm(st, w.G, FF, F(18), D, w.Y, D, S, D, FF, nullptr);
    k_rmsnorm<<<S / 4, 256, 0, st>>>(w.Y, F(15), out_b, 0.5f, out_b, S);
    if (ch3) hipMemcpyAsync(ch3, out_b, nd * 4, hipMemcpyDeviceToDevice, st);
    gemm(st, out_b, D, F(20), D, w.Y, D, S, D, D, nullptr);
    gemm(st, p, PLE, F(19), D, w.A, D, S, D, PLE, nullptr);
    k_sigmul<<<(unsigned)((nd + 255) / 256), 256, 0, st>>>(w.Y, w.A, nd);
    k_rmsnorm<<<S / 4, 256, 0, st>>>(w.Y, F(21), out_b, 1.0f, out_b, S);
}
}
extern "C" void kernel_launch(void* const* d_in, const int* in_sizes, int n_in, void* d_out, int out_size, void* d_ws, size_t ws_size, hipStream_t stream) {
    using namespace nv;
    char* ws = (char*)d_ws; size_t off = 0;
    auto take = [&](size_t bytes) { char* p = ws + off; off += (bytes + 255) & ~(size_t)255; return (float*)p; };
    Bufs w;
    w.A = take((size_t)S * D * 4); w.G = take((size_t)S * FF * 4); w.U = take((size_t)S * FF * 4); w.Y = take((size_t)S * D * 4);
    w.Z = take((size_t)S * INW * 4); w.R = take((size_t)S * 512 * 4); w.MIX = take((size_t)S * D * 4);
    for (int b = 0; b < 8; ++b) forward_batch(stream, d_in, (float*)d_out + (size_t)b * S * D, b, w, nullptr, nullptr, nullptr, nullptr, nullptr, nullptr);
}
```

```cpp
#include <hip/hip_runtime.h>
#include <cstdio>
#include <cstdint>
namespace pg8 {
#define PG8_LAS __attribute__((address_space(3)))
typedef unsigned short bf16_t;
typedef short bf16x8 __attribute__((ext_vector_type(8)));
typedef float f32x4 __attribute__((ext_vector_type(4)));
typedef unsigned u32x4 __attribute__((ext_vector_type(4)));
constexpr int BM = 256, BK = 64, HALF = 128, HTB = HALF * BK * 2  , STAGE_BYTES = 8 * HTB, NXCD = 8, WGM = 8;

__host__ __device__ __forceinline__ int lds_byte(int r, int c) { const int st = (r >> 4) * 2 + (c >> 5), rr = r & 15, cc = c & 31, ob = rr * 64 + cc * 2; return st * 1024 + (ob ^ (((ob >> 9) & 1) << 5)); }
__host__ __device__ __forceinline__ void stage_rc(int b, int& R, int& C) { const int st = b / 1024, sb = b % 1024, swz = sb ^ (((sb >> 9) & 1) << 5); R = (st >> 1) * 16 + swz / 64; C = (st & 1) * 32 + (swz % 64) / 2; }
__host__ __device__ __forceinline__ int perm32(int rho) { const int n = rho >> 4, i = rho & 15; return 8 * (i >> 2) + 4 * n + (i & 3); }

struct Unit { int pm, pn; };
struct Gemm { const bf16_t* A; const bf16_t* Bt; int M, N, K; };

struct StaticOrder {
    int nM, nN, nwg, G, c;
    __host__ __device__ void init(int M, int N, int G_, int c_) { nM = M / BM; nN = N / BM; nwg = nM * nN; G = G_; c = c_; }
    __host__ __device__ bool next(int i, Unit& u) const {
        const long L = (long)i * G + c; if (L >= nwg) return false;
        int wgid = (int)L; { const int q = nwg / NXCD, r = nwg % NXCD, xcd = wgid % NXCD, off = wgid / NXCD; wgid = (xcd < r ? xcd * (q + 1) : r * (q + 1) + (xcd - r) * q) + off; }
        const int nig = WGM * nN, gid = wgid / nig, fm = gid * WGM, gsz = (nM - fm) < WGM ? (nM - fm) : WGM;
        u.pm = fm + ((wgid % nig) % gsz); u.pn = (wgid % nig) / gsz; return true;
    }
    __device__ __forceinline__ void a_ready(const Unit&) const {}
    __device__ __forceinline__ void done(const Unit&) const {}
};

typedef float f32x2 __attribute__((ext_vector_type(2)));
typedef __bf16 bf16x2_t __attribute__((ext_vector_type(2)));
__device__ __forceinline__ unsigned cvt_pk_bf16(float lo, float hi) { f32x2 v = {lo, hi}; bf16x2_t b = __builtin_convertvector(v, bf16x2_t); return __builtin_bit_cast(unsigned, b); }
__device__ __forceinline__ float bf_lo(unsigned u) { return __uint_as_float(u << 16); }
__device__ __forceinline__ float bf_hi(unsigned u) { return __uint_as_float(u & 0xffff0000u); }
__device__ __forceinline__ float fsilu(float v) { return v * __builtin_amdgcn_rcpf(1.0f + __builtin_amdgcn_exp2f(-1.4426950408889634f * v)); }
__device__ __forceinline__ float fsigmoid(float v) { return __builtin_amdgcn_rcpf(1.0f + __builtin_amdgcn_exp2f(-1.4426950408889634f * v)); }

struct EpiGateUp {
    static constexpr bool AFTER_DRAIN = false;
    bf16_t* H; const float* rs; int ldh;
    __device__ __forceinline__ void operator()(const f32x4 (&acc)[2][2][4][2], const Unit& u, int wr, int wc, int fr, int fq) const {
        const int row0 = u.pm * BM + wr * 64 + fr, col0 = u.pn * 128 + wc * 32 + 8 * fq;
#pragma unroll
        for (int ai = 0; ai < 2; ++ai)
#pragma unroll
            for (int m = 0; m < 4; ++m) {
                const int row = row0 + ai * HALF + m * 16; const float r = rs[row];
                float hv[8];
#pragma unroll
                for (int n = 0; n < 2; ++n)
#pragma unroll
                    for (int j = 0; j < 4; ++j) hv[4 * n + j] = fsilu(acc[ai][0][m][n][j] * r) * (acc[ai][1][m][n][j] * r);
                u32x4 w; w.x = cvt_pk_bf16(hv[0], hv[1]); w.y = cvt_pk_bf16(hv[2], hv[3]); w.z = cvt_pk_bf16(hv[4], hv[5]); w.w = cvt_pk_bf16(hv[6], hv[7]);
                *(u32x4*)(H + (size_t)row * ldh + col0) = w;
            }
    }
};
template <int MODE> struct EpiStats {
    static constexpr bool AFTER_DRAIN = false;
    bf16_t* Y; float* PS; const bf16_t* PP; int ldc;
    __device__ __forceinline__ void operator()(const f32x4 (&acc)[2][2][4][2], const Unit& u, int wr, int wc, int fr, int fq) const {
        const int row0 = u.pm * BM + wr * 64 + fr, col0 = u.pn * BM + wc * 32 + 8 * fq;
#pragma unroll
        for (int ai = 0; ai < 2; ++ai)
#pragma unroll
            for (int m = 0; m < 4; ++m) {
                const int row = row0 + ai * HALF + m * 16; float ss = 0.f;
#pragma unroll
                for (int bj = 0; bj < 2; ++bj) {
                    float v[8];
#pragma unroll
                    for (int n = 0; n < 2; ++n)
#pragma unroll
                        for (int j = 0; j < 4; ++j) v[4 * n + j] = acc[ai][bj][m][n][j];
                    if (MODE == 1) {
                        const u32x4 pw = *(const u32x4*)(PP + (size_t)row * ldc + col0 + bj * HALF);
                        v[0] = fsigmoid(v[0]) * bf_lo(pw.x); v[1] = fsigmoid(v[1]) * bf_hi(pw.x); v[2] = fsigmoid(v[2]) * bf_lo(pw.y); v[3] = fsigmoid(v[3]) * bf_hi(pw.y);
                        v[4] = fsigmoid(v[4]) * bf_lo(pw.z); v[5] = fsigmoid(v[5]) * bf_hi(pw.z); v[6] = fsigmoid(v[6]) * bf_lo(pw.w); v[7] = fsigmoid(v[7]) * bf_hi(pw.w);
                    }
#pragma unroll
                    for (int k = 0; k < 8; ++k) ss += v[k] * v[k];
                    u32x4 w; w.x = cvt_pk_bf16(v[0], v[1]); w.y = cvt_pk_bf16(v[2], v[3]); w.z = cvt_pk_bf16(v[4], v[5]); w.w = cvt_pk_bf16(v[6], v[7]);
                    *(u32x4*)(Y + (size_t)row * ldc + col0 + bj * HALF) = w;
                }
                ss += __shfl_xor(ss, 16); ss += __shfl_xor(ss, 32);
                if (fq == 0) PS[(size_t)row * 16 + u.pn * 4 + wc] = ss;
            }
    }
};
struct EpiPlain {
    static constexpr bool AFTER_DRAIN = false;
    bf16_t* Y; int ldc;
    __device__ __forceinline__ void operator()(const f32x4 (&acc)[2][2][4][2], const Unit& u, int wr, int wc, int fr, int fq) const {
        const int row0 = u.pm * BM + wr * 64 + fr, col0 = u.pn * BM + wc * 32 + 8 * fq;
#pragma unroll
        for (int ai = 0; ai < 2; ++ai)
#pragma unroll
            for (int m = 0; m < 4; ++m) {
                const int row = row0 + ai * HALF + m * 16;
#pragma unroll
                for (int bj = 0; bj < 2; ++bj) {
                    const f32x4 a = acc[ai][bj][m][0], b = acc[ai][bj][m][1];
                    u32x4 w; w.x = cvt_pk_bf16(a[0], a[1]); w.y = cvt_pk_bf16(a[2], a[3]); w.z = cvt_pk_bf16(b[0], b[1]); w.w = cvt_pk_bf16(b[2], b[3]);
                    *(u32x4*)(Y + (size_t)row * ldc + col0 + bj * HALF) = w;
                }
            }
    }
};
__constant__ float c_inv_freq[32] = {1.000000000e+00f, 7.498942018e-01f, 5.623413324e-01f, 4.216965139e-01f, 3.162277639e-01f, 2.371373773e-01f, 1.778279394e-01f, 1.333521456e-01f,
    1.000000015e-01f, 7.498942316e-02f, 5.623413250e-02f, 4.216964915e-02f, 3.162277490e-02f, 2.371373773e-02f, 1.778279431e-02f, 1.333521400e-02f,
    9.999999776e-03f, 7.498942316e-03f, 5.623413250e-03f, 4.216964822e-03f, 3.162277630e-03f, 2.371373819e-03f, 1.778279431e-03f, 1.333521446e-03f,
    1.000000047e-03f, 7.498941850e-04f, 5.623413017e-04f, 4.216965172e-04f, 3.162277571e-04f, 2.371373703e-04f, 1.778279402e-04f, 1.333521504e-04f};
__device__ __forceinline__ float log2_gamma(int h) { return h == 0 ? -0.04580368961312479f : h == 1 ? -0.02272007650008353f : h == 2 ? -0.011315313227834146f : -0.005646563141142063f; }
struct EpiWin {
    static constexpr bool AFTER_DRAIN = false;
    bf16_t* Z; const float* rs; const float* bias; const int* pos; int ldz;
    __device__ __forceinline__ void operator()(const f32x4 (&acc)[2][2][4][2], const Unit& u, int wr, int wc, int fr, int fq) const {
        const int row0 = u.pm * BM + wr * 64 + fr;
        if (u.pn < 2) {
#pragma unroll
            for (int bj = 0; bj < 2; ++bj) {
                const int gi = 4 * bj + wc, head = gi >> 1, q = gi & 1, dlo = 16 * q + 4 * fq, lcol = u.pn * 256 + 64 * head + dlo;
                const f32x4 b1 = *(const f32x4*)(bias + lcol), b2 = *(const f32x4*)(bias + lcol + 32), fv = *(const f32x4*)(c_inv_freq + dlo);
                const float lg = log2_gamma(head);
#pragma unroll
                for (int ai = 0; ai < 2; ++ai)
#pragma unroll
                    for (int m = 0; m < 4; ++m) {
                        const int row = row0 + ai * HALF + m * 16; const float r = rs[row]; const float p = (float)pos[row]; const int ci = row & 127;
                        const float sc = u.pn == 0 ? __builtin_amdgcn_exp2f((float)ci * lg) : 0.125f * __builtin_amdgcn_exp2f(-(float)ci * lg);
                        float o1[4], o2[4];
#pragma unroll
                        for (int j = 0; j < 4; ++j) {
                            const float x1 = acc[ai][bj][m][0][j] * r + b1[j], x2 = acc[ai][bj][m][1][j] * r + b2[j];
                            const float ang = p * fv[j];
                            const float k = __builtin_rintf(ang * 0.15915494309189535f);
                            float rr = __builtin_fmaf(-k, 6.28125f, ang); rr = __builtin_fmaf(-k, 0.001935307179586232f, rr);
                            const float xr = rr * 0.15915494309189535f;
                            const float cs = __builtin_amdgcn_cosf(xr), sn = __builtin_amdgcn_sinf(xr);
                            o1[j] = (x1 * cs - x2 * sn) * sc; o2[j] = (x2 * cs + x1 * sn) * sc;
                        }
                        unsigned long long w1 = (unsigned long long)cvt_pk_bf16(o1[0], o1[1]) | ((unsigned long long)cvt_pk_bf16(o1[2], o1[3]) << 32);
                        unsigned long long w2 = (unsigned long long)cvt_pk_bf16(o2[0], o2[1]) | ((unsigned long long)cvt_pk_bf16(o2[2], o2[3]) << 32);
                        *(unsigned long long*)(Z + (size_t)row * ldz + lcol) = w1;
                        *(unsigned long long*)(Z + (size_t)row * ldz + lcol + 32) = w2;
                    }
            }
        } else {
            const int col0 = u.pn * BM + wc * 32 + 8 * fq;
            const int mode = (u.pn == 4 || u.pn == 5) ? 1 : (u.pn == 6 || u.pn == 7) ? 2 : 0;
#pragma unroll
            for (int bj = 0; bj < 2; ++bj) {
                const f32x4 b1 = *(const f32x4*)(bias + col0 + bj * HALF), b2 = *(const f32x4*)(bias + col0 + bj * HALF + 4);
#pragma unroll
                for (int ai = 0; ai < 2; ++ai)
#pragma unroll
                    for (int m = 0; m < 4; ++m) {
                        const int row = row0 + ai * HALF + m * 16; const float r = rs[row];
                        float v[8];
#pragma unroll
                        for (int j = 0; j < 4; ++j) { v[j] = acc[ai][bj][m][0][j] * r + b1[j]; v[4 + j] = acc[ai][bj][m][1][j] * r + b2[j]; }
                        if (mode == 1) {
#pragma unroll
                            for (int k = 0; k < 8; ++k) v[k] = fsilu(v[k]);
                        } else if (mode == 2) {
#pragma unroll
                            for (int k = 0; k < 8; ++k) v[k] *= 0.18033688011112042f;
                        }
                        u32x4 w; w.x = cvt_pk_bf16(v[0], v[1]); w.y = cvt_pk_bf16(v[2], v[3]); w.z = cvt_pk_bf16(v[4], v[5]); w.w = cvt_pk_bf16(v[6], v[7]);
                        *(u32x4*)(Z + (size_t)row * ldz + col0 + bj * HALF) = w;
                    }
            }
        }
    }
};
template <class Epi, class Sched, bool ALIGN_EPI = false, bool SP2 = false>
__device__ __forceinline__ void gemm_phase(PG8_LAS unsigned char* lds, const Gemm g, const Sched& S, const Epi& E) {
    const int tid = threadIdx.x, wid = __builtin_amdgcn_readfirstlane(tid >> 6), lane = tid & 63, wr = wid >> 2, wc = wid & 3, fr = lane & 15, fq = lane >> 4;
    const int K = g.K, nt = K / BK;
    unsigned voffA[2], voffB[2];
#pragma unroll
    for (int i = 0; i < 2; ++i) { int R, C; stage_rc(tid * 16 + i * 8192, R, C); const int Rb = R;
        voffA[i] = (unsigned)(R * K + C) * 2u; voffB[i] = (unsigned)(Rb * K + C) * 2u; }
    const size_t kstep = (size_t)(BK * 2);
    const size_t hstep = (size_t)HALF * K * 2;
    const size_t tstep = 2 * hstep;
    const unsigned ldsw = (unsigned)wid * 1024u;
    const int aoff = lds_byte(wr * 64 + fr, fq * 8), boff = lds_byte(wc * 32 + fr, fq * 8);
#define PG8_SA(b, h) (((b) * 2 + (h)) * HTB)
#define PG8_SB(b, h) ((4 + (b) * 2 + (h)) * HTB)
#define PG8_STAGE(bufoff, gbase, voff) do { _Pragma("unroll") for (int _i = 0; _i < 2; ++_i) \
        __builtin_amdgcn_global_load_lds((const unsigned*)((const char*)(gbase) + (voff)[_i]), (PG8_LAS unsigned*)(lds + (bufoff) + ldsw + _i * 8192), 16, 0, 0); } while (0)
#define PG8_LDA(dst, b, h) do { _Pragma("unroll") for (int m = 0; m < 4; ++m) _Pragma("unroll") for (int k = 0; k < 2; ++k) dst[m][k] = *(const PG8_LAS bf16x8*)(lds + PG8_SA(b, h) + aoff + m * 2048 + k * 1024); } while (0)
#define PG8_LDB(dst, b, h) do { _Pragma("unroll") for (int n = 0; n < 2; ++n) _Pragma("unroll") for (int k = 0; k < 2; ++k) dst[n][k] = *(const PG8_LAS bf16x8*)(lds + PG8_SB(b, h) + boff + n * 2048 + k * 1024); } while (0)
#define PG8_MMA(ai, bj, At, Bt) do { __builtin_amdgcn_s_setprio(1); _Pragma("unroll") for (int m = 0; m < 4; ++m) _Pragma("unroll") for (int n = 0; n < 2; ++n) _Pragma("unroll") for (int k = 0; k < 2; ++k) \
        acc[ai][bj][m][n] = __builtin_amdgcn_mfma_f32_16x16x32_bf16(Bt[n][k], At[m][k], acc[ai][bj][m][n], 0, 0, 0); __builtin_amdgcn_s_setprio(0); } while (0)
#define PG8_WAIT_V(n) asm volatile("s_waitcnt vmcnt(" #n ")" ::: "memory")
#define PG8_WAIT_L(n) asm volatile("s_waitcnt lgkmcnt(" #n ")" ::: "memory")
#define PG8_BAR __builtin_amdgcn_s_barrier()
#define PG8_SCHED __builtin_amdgcn_sched_barrier(0)
    Unit cur, nxt; int ui = 0;
    if (!S.next(0, cur)) return;
    f32x4 acc[2][2][4][2];
#pragma unroll
    for (int a = 0; a < 2; ++a)
#pragma unroll
        for (int b = 0; b < 2; ++b)
#pragma unroll
            for (int m = 0; m < 4; ++m)
#pragma unroll
                for (int n = 0; n < 2; ++n) acc[a][b][m][n] = (f32x4){0.f, 0.f, 0.f, 0.f};
    bf16x8 At[4][2], B0[2][2], B1[2][2];
    const char* cA = (const char*)g.A + (size_t)cur.pm * tstep; const char* cB = (const char*)g.Bt + (size_t)cur.pn * tstep;
    S.a_ready(cur);
    if constexpr (SP2) {
        PG8_STAGE(PG8_SB(0, 0), cB, voffB); PG8_STAGE(PG8_SB(0, 1), cB + hstep, voffB); PG8_STAGE(PG8_SA(0, 0), cA, voffA); PG8_STAGE(PG8_SA(0, 1), cA + hstep, voffA);
        if (wr == 1) PG8_BAR;
        PG8_WAIT_V(2); PG8_BAR;
        PG8_STAGE(PG8_SB(1, 0), cB + kstep, voffB); PG8_STAGE(PG8_SA(1, 0), cA + kstep, voffA); PG8_STAGE(PG8_SB(1, 1), cB + hstep + kstep, voffB);
        PG8_WAIT_V(6); PG8_BAR;
    } else {
        PG8_STAGE(PG8_SB(0, 0), cB, voffB); PG8_STAGE(PG8_SA(0, 0), cA, voffA); PG8_STAGE(PG8_SB(0, 1), cB + hstep, voffB); PG8_STAGE(PG8_SA(0, 1), cA + hstep, voffA);
        if (wr == 1) PG8_BAR;
        PG8_WAIT_V(4); PG8_BAR;
        PG8_STAGE(PG8_SB(1, 0), cB + kstep, voffB); PG8_STAGE(PG8_SA(1, 0), cA + kstep, voffA); PG8_STAGE(PG8_SB(1, 1), cB + hstep + kstep, voffB);
        PG8_WAIT_V(6); PG8_BAR;
    }
    for (;;) {
        const bool has_next = S.next(ui + 1, nxt);
        const char* nA = has_next ? (const char*)g.A + (size_t)nxt.pm * tstep : cA; const char* nB = has_next ? (const char*)g.Bt + (size_t)nxt.pn * tstep : cB;
        for (int t = 0; t < nt; t += 2) {
            const bool last = (t == nt - 2);
            const char* a1 = cA + (size_t)(t + 1) * kstep;
            const char* a2 = last ? nA : cA + (size_t)(t + 2) * kstep; const char* b2 = last ? nB : cB + (size_t)(t + 2) * kstep;
            const char* a3 = a2 + kstep; const char* b3 = b2 + kstep;
            if (last && has_next) S.a_ready(nxt);
            if constexpr (SP2) {
            PG8_LDB(B0, 0, 0); PG8_LDB(B1, 0, 1); PG8_SCHED; PG8_LDA(At, 0, 0); PG8_STAGE(PG8_SA(1, 1), a1 + hstep, voffA);
            PG8_WAIT_V(8); PG8_WAIT_L(0); PG8_BAR; PG8_MMA(0, 0, At, B0); PG8_MMA(0, 1, At, B1); PG8_BAR; PG8_SCHED;
            PG8_LDA(At, 0, 1); PG8_STAGE(PG8_SB(0, 0), b2, voffB); PG8_STAGE(PG8_SB(0, 1), b2 + hstep, voffB); PG8_STAGE(PG8_SA(0, 0), a2, voffA);
            PG8_WAIT_V(8); PG8_WAIT_L(0); PG8_BAR; PG8_MMA(1, 0, At, B0); PG8_MMA(1, 1, At, B1); PG8_BAR; PG8_SCHED;
            PG8_LDB(B0, 1, 0); PG8_LDB(B1, 1, 1); PG8_SCHED; PG8_LDA(At, 1, 0); PG8_STAGE(PG8_SA(0, 1), a2 + hstep, voffA);
            PG8_WAIT_V(8); PG8_WAIT_L(0); PG8_BAR; PG8_MMA(0, 0, At, B0); PG8_MMA(0, 1, At, B1); PG8_BAR; PG8_SCHED;
            PG8_LDA(At, 1, 1); PG8_STAGE(PG8_SB(1, 0), b3, voffB); PG8_STAGE(PG8_SB(1, 1), b3 + hstep, voffB); PG8_STAGE(PG8_SA(1, 0), a3, voffA);
            PG8_WAIT_V(8); PG8_WAIT_L(0); PG8_BAR; PG8_MMA(1, 0, At, B0); PG8_MMA(1, 1, At, B1); PG8_BAR; PG8_SCHED;
            } else {
            PG8_LDB(B0, 0, 0); PG8_SCHED; PG8_LDA(At, 0, 0); PG8_STAGE(PG8_SA(1, 1), a1 + hstep, voffA);
            PG8_WAIT_L(8); PG8_BAR; PG8_WAIT_L(0); PG8_MMA(0, 0, At, B0); PG8_BAR; PG8_SCHED;
            PG8_LDB(B1, 0, 1); PG8_STAGE(PG8_SB(0, 0), b2, voffB);
            PG8_BAR; PG8_WAIT_L(0); PG8_MMA(0, 1, At, B1); PG8_BAR;
            PG8_LDA(At, 0, 1); PG8_STAGE(PG8_SA(0, 0), a2, voffA);
            PG8_BAR; PG8_WAIT_L(0); PG8_MMA(1, 0, At, B0); PG8_BAR; PG8_SCHED;
            PG8_STAGE(PG8_SB(0, 1), b2 + hstep, voffB);
            PG8_WAIT_V(6); PG8_BAR; PG8_MMA(1, 1, At, B1); PG8_BAR;
            PG8_LDB(B0, 1, 0); PG8_SCHED; PG8_LDA(At, 1, 0); PG8_STAGE(PG8_SA(0, 1), a2 + hstep, voffA);
            PG8_WAIT_L(8); PG8_BAR; PG8_WAIT_L(0); PG8_MMA(0, 0, At, B0); PG8_BAR; PG8_SCHED;
            PG8_LDB(B1, 1, 1); PG8_STAGE(PG8_SB(1, 0), b3, voffB);
            PG8_BAR; PG8_WAIT_L(0); PG8_MMA(0, 1, At, B1); PG8_BAR;
            PG8_LDA(At, 1, 1); PG8_STAGE(PG8_SA(1, 0), a3, voffA);
            PG8_BAR; PG8_WAIT_L(0); PG8_MMA(1, 0, At, B0); PG8_BAR; PG8_SCHED;
            PG8_STAGE(PG8_SB(1, 1), b3 + hstep, voffB);
            PG8_WAIT_V(6); PG8_BAR; PG8_MMA(1, 1, At, B1); PG8_BAR;
            }
        }
        if constexpr (ALIGN_EPI) { if (wr == 0) PG8_BAR; }
        if constexpr (!Epi::AFTER_DRAIN) { E(acc, cur, wr, wc, fr, fq); S.done(cur); }
        if (!has_next) break;
#pragma unroll
        for (int a = 0; a < 2; ++a)
#pragma unroll
            for (int b = 0; b < 2; ++b)
#pragma unroll
                for (int m = 0; m < 4; ++m)
#pragma unroll
                    for (int n = 0; n < 2; ++n) acc[a][b][m][n] = (f32x4){0.f, 0.f, 0.f, 0.f};
        cur = nxt; cA = nA; cB = nB; ++ui;
        if constexpr (ALIGN_EPI) { if (wr == 1) PG8_BAR; }
    }
    PG8_WAIT_V(0);
    if constexpr (!ALIGN_EPI) { if (wr == 0) PG8_BAR; }
    PG8_BAR;
    if constexpr (Epi::AFTER_DRAIN) { E.fused(acc, cur, wr, wc, fr, fq, lds, wid, lane); S.done(cur); }
#undef PG8_SA
#undef PG8_SB
#undef PG8_STAGE
#undef PG8_LDA
#undef PG8_LDB
#undef PG8_MMA
#undef PG8_WAIT_V
#undef PG8_WAIT_L
#undef PG8_BAR
#undef PG8_SCHED
}
}
#define GAS __attribute__((address_space(1)))
#define LAS __attribute__((address_space(3)))
typedef unsigned short bf16;
typedef unsigned v4u __attribute__((ext_vector_type(4)));
typedef float f32x4 __attribute__((ext_vector_type(4)));
typedef short bf16x8 __attribute__((ext_vector_type(8)));
typedef GAS unsigned gu32;
typedef GAS unsigned long long gu64;
#define RLX_AGENT __ATOMIC_RELAXED, __HIP_MEMORY_SCOPE_AGENT
#define LDS_WAIT() asm volatile("s_waitcnt lgkmcnt(0)" ::: "memory")
#define VM_WAIT() asm volatile("s_waitcnt vmcnt(0)" ::: "memory")
__device__ __forceinline__ unsigned long long rt() { return __builtin_amdgcn_s_memrealtime(); }
__device__ __forceinline__ unsigned f2bf(float f) { unsigned u = __builtin_bit_cast(unsigned, f); return (u + 0x7fffu + ((u >> 16) & 1u)) >> 16; }
__device__ __forceinline__ unsigned pk2(float lo, float hi) { return f2bf(lo) | (f2bf(hi) << 16); }

#define XB_TMO      128
#define XB_XCNT(j)  (256  + 64 * (j))
#define XB_XSUB(j)  (1280 + 64 * (j))
#define XB_XGEN(j)  (2304 + 64 * (j))
#define XB_TOP      3328
#define XB_TOPGEN   3392
#define XCD_BAR_WORDS 3456
#define XB_SPIN_CAP (1u << 18)

__device__ __forceinline__ unsigned xb_ld(unsigned* p)              { return __hip_atomic_load(p, __ATOMIC_RELAXED, __HIP_MEMORY_SCOPE_AGENT); }
__device__ __forceinline__ unsigned xb_add(unsigned* p, unsigned v) { return __hip_atomic_fetch_add(p, v, __ATOMIC_RELAXED, __HIP_MEMORY_SCOPE_AGENT); }
__device__ __forceinline__ unsigned xb_xcc_id() { return (unsigned)__builtin_amdgcn_s_getreg((3 << 11) | 20) & 0xFu; }
#define XB_SPIN(cond, bar) do { unsigned _sp = 0; while (cond) { __builtin_amdgcn_s_sleep(1); \
    if ((++_sp & 255u) == 0u) { if (xb_ld(&(bar)[XB_TMO])) break; if (_sp > XB_SPIN_CAP) { atomicAdd(&(bar)[XB_TMO], 1u); break; } } } } while (0)

struct XcdBarrier {
    unsigned* bar; unsigned x;
    volatile LAS unsigned* st;
};

__device__ __forceinline__ XcdBarrier xcd_barrier_post(unsigned* bar, volatile LAS unsigned* st) {
    XcdBarrier b; b.bar = bar; b.x = xb_xcc_id(); b.st = st;
    if (threadIdx.x == 0) (void)xb_add(&bar[XB_XCNT(b.x)], 1u);
    return b;
}
__device__ __forceinline__ void xcd_barrier_complete(unsigned* bar, unsigned x, unsigned& nloc, unsigned& nx) {
    const unsigned G = gridDim.x * gridDim.y * gridDim.z;
    unsigned sum, cnt, mine, sp = 0u;
    for (;;) {
        sum = 0u; cnt = 0u; mine = 0u;
#pragma unroll
        for (unsigned j = 0; j < 16; ++j) { const unsigned c = xb_ld(&bar[XB_XCNT(j)]); sum += c; cnt += (c > 0u) ? 1u : 0u; mine = (j == x) ? c : mine; }
        if (sum == G) break;
        __builtin_amdgcn_s_sleep(1);
        if ((++sp & 255u) == 0u) { if (xb_ld(&bar[XB_TMO])) break; if (sp > XB_SPIN_CAP) { atomicAdd(&bar[XB_TMO], 1u); break; } }
    }
    nloc = mine > 0u ? mine : 1u; nx = cnt > 0u ? cnt : 1u;
}

__device__ __forceinline__ void xcd_barrier(const XcdBarrier& b) {
    asm volatile("s_waitcnt vmcnt(0)" ::: "memory");
    __syncthreads();
    if (threadIdx.x == 0) {
        unsigned* bar = b.bar;
        __builtin_amdgcn_s_waitcnt(0);
        unsigned nloc = b.st[0], nx = b.st[1];
        if (nloc == 0u) { xcd_barrier_complete(bar, b.x, nloc, nx); b.st[0] = nloc; b.st[1] = nx; }
        const unsigned old = xb_add(&bar[XB_XSUB(b.x)], 1u);
        const unsigned gen = old / nloc;
        if (old + 1u == (gen + 1u) * nloc) {
            __builtin_amdgcn_fence(__ATOMIC_RELEASE, "agent");
            asm volatile("s_waitcnt vmcnt(0)" ::: "memory");
            const unsigned og = xb_add(&bar[XB_TOP], 1u);
            const unsigned tg = og / nx;
            if (og + 1u == (tg + 1u) * nx) xb_add(&bar[XB_TOPGEN], 1u);
            else XB_SPIN(xb_ld(&bar[XB_TOPGEN]) == tg, bar);
            __builtin_amdgcn_fence(__ATOMIC_ACQUIRE, "agent");
            xb_add(&bar[XB_XGEN(b.x)], 1u);
            asm volatile("s_waitcnt vmcnt(0)" ::: "memory");
        } else {
            XB_SPIN(xb_ld(&bar[XB_XGEN(b.x)]) == gen, bar);
            __builtin_amdgcn_fence(__ATOMIC_ACQUIRE, "agent");
            asm volatile("s_waitcnt vmcnt(0)" ::: "memory");
        }
    }
    __syncthreads();
}
#ifndef NBATCH
#define NBATCH 8
#endif
constexpr int NWAVES = 8;
constexpr int BATCH = NBATCH, SEQ = 4096, DM = 1024, FF = 2816, INW = 2304, PLE = 256, CH = 128;
constexpr int M = BATCH * SEQ;
constexpr float RMS_EPS = 1e-6f;
constexpr int NUNIT_RET = BATCH * 32 * 4;

constexpr size_t MiB = 1u << 20;
constexpr size_t WS_CTL = 0, CTL_ZERO_BYTES = 1 * MiB;
constexpr size_t WS_W1GU = 2 * MiB;
constexpr size_t WS_W1D = WS_W1GU + 11 * MiB;
constexpr size_t WS_WIN = WS_W1D + 6 * MiB;
constexpr size_t WS_WOUT = WS_WIN + 5 * MiB;
constexpr size_t WS_W2GU = WS_WOUT + 2 * MiB;
constexpr size_t WS_W2D = WS_W2GU + 11 * MiB;
constexpr size_t WS_WPG = WS_W2D + 6 * MiB;
constexpr size_t WS_WPP = WS_WPG + 2 * MiB;
constexpr size_t WS_RS = WS_WPP + 1 * MiB;
constexpr size_t WS_PS = WS_RS + 1 * MiB;
constexpr size_t WS_PB = WS_PS + 2 * MiB;
constexpr size_t WS_XB = WS_PB + (size_t)M * PLE * 2;
constexpr size_t WS_Y = WS_XB + (size_t)M * DM * 2;
constexpr size_t WS_H = WS_Y + (size_t)M * DM * 2;
constexpr size_t WS_KV = WS_H + (size_t)M * INW * 2;
constexpr size_t WS_ST = WS_H + (size_t)M * FF * 2;
constexpr size_t WS_END = WS_ST + (size_t)M * 512;
static_assert(WS_KV + (size_t)M * 1024 <= WS_ST, "KV inside H region");
static_assert(WS_END <= 512 * MiB, "d_ws map");

constexpr int RING_OFF = 0, RING_BYTES = 131072;
constexpr int LDSCTL_OFF = RING_BYTES, MISC_OFF = LDSCTL_OFF + 320;
constexpr int LDS_BYTES = 147456;
static_assert(MISC_OFF + 128 <= LDS_BYTES, "LDS map");

struct Frame {
    LAS unsigned char* lds;
    volatile LAS unsigned* MISC;
    gu32* ctl;
    int tid, lane, wave;
    int vcu, G;
    void* const* dummy;
};

__device__ __forceinline__ float wave_sum(float v) {
#pragma unroll
    for (int o = 1; o < 64; o <<= 1) v += __shfl_xor(v, o);
    return v;
}
typedef float f32x16 __attribute__((ext_vector_type(16)));
typedef float f32x2v __attribute__((ext_vector_type(2)));
typedef short s16x4 __attribute__((ext_vector_type(4)));
typedef short v4i16_t __attribute__((ext_vector_type(4)));
typedef const LAS unsigned char* lds_cptr;
__device__ __forceinline__ int crow(int r, int hi) { return (r & 3) + 8 * (r >> 2) + 4 * hi; }
__device__ __forceinline__ s16x4 vtr(lds_cptr p) { return __builtin_bit_cast(s16x4, __builtin_amdgcn_ds_read_tr16_b64_v4i16((LAS v4i16_t*)p)); }
__device__ __forceinline__ bf16x8 cat8(s16x4 lo, s16x4 hi) { return (bf16x8){lo[0], lo[1], lo[2], lo[3], hi[0], hi[1], hi[2], hi[3]}; }
__device__ __forceinline__ unsigned cvtpk(float lo, float hi) { return pg8::cvt_pk_bf16(lo, hi); }
__device__ __forceinline__ float bflo(unsigned u) { return __uint_as_float(u << 16); }
__device__ __forceinline__ float bfhi(unsigned u) { return __uint_as_float(u & 0xffff0000u); }

__host__ __device__ __forceinline__ int iperm32(int o) { return 16 * ((o >> 2) & 1) + 4 * (o >> 3) + (o & 3); }
struct MapPerm { __device__ __forceinline__ int operator()(int c) const { return (c & ~31) + iperm32(c & 31); } };
struct MapGU { int bj; __device__ __forceinline__ int operator()(int c) const { const int pn = c >> 7, w = c & 127; return 256 * pn + 128 * bj + (w & ~31) + iperm32(w & 31); } };
struct MapWin { __device__ __forceinline__ int operator()(int c) const {
    if (c >= 512) return (c & ~31) + iperm32(c & 31);
    const int t = c >> 8, cc = c & 255, head = cc >> 6, d = cc & 63, n = d >> 5, dl = d & 31, q = dl >> 4, r = dl & 15, gi = head * 2 + q;
    return 256 * t + 128 * (gi >> 2) + 32 * (gi & 3) + 16 * n + r; } };
template <class Map>
__device__ __forceinline__ void p0_item(const float* W, int K, int N, const float* g, bf16* WT, const Map map, LAS float* scr, int item, int lane) {
    const int nblk = N / 32, kb = item / nblk, nb = item % nblk, k0 = 64 * kb, n0 = 32 * nb;
#pragma unroll 8
    for (int i = 0; i < 32; ++i) { const int kk = 2 * i + (lane >> 5); float v = W[(size_t)(k0 + kk) * N + n0 + (lane & 31)]; if (g) v *= g[k0 + kk]; scr[kk * 33 + (lane & 31)] = v; }
    LDS_WAIT(); asm volatile("" ::: "memory");
    const int c = lane & 7;
#pragma unroll
    for (int j = 0; j < 4; ++j) { const int n = (lane >> 3) + 8 * j; const LAS float* s = scr + (8 * c) * 33 + n;
        v4u o; o.x = cvtpk(s[0 * 33], s[1 * 33]); o.y = cvtpk(s[2 * 33], s[3 * 33]); o.z = cvtpk(s[4 * 33], s[5 * 33]); o.w = cvtpk(s[6 * 33], s[7 * 33]);
        *(GAS v4u*)(WT + (size_t)map(n0 + n) * K + k0 + 8 * c) = o; }
    LDS_WAIT(); asm volatile("" ::: "memory");
}
struct Ptrs {
    const float *x, *p; const int* pos;
    const float *g1pre, *g1post, *w1g, *w1u, *w1d, *gmpre, *gmpost, *win, *bin, *sinks, *wout, *g2pre, *g2post, *w2g, *w2u, *w2d, *wpp, *wpg, *gple;
    float* out;
    bf16 *W1GU, *W1D, *WIN, *WOUT, *W2GU, *W2D, *WPG, *WPP, *PB, *XB, *Y, *H, *Z, *PP, *ST;
    float *RS, *PS, *KV;
};
__device__ __forceinline__ void p0_prologue(Frame& F, const Ptrs& P) {
    LAS float* scr = (LAS float*)(F.lds + RING_OFF + F.wave * 16384);
    const int gw = F.vcu * NWAVES + F.wave, NGW = F.G * NWAVES;
    constexpr int I_GU = (DM / 64) * (FF / 32), I_D = (FF / 64) * (DM / 32), I_IN = (DM / 64) * (INW / 32), I_SQ = (DM / 64) * (DM / 32), I_PP = (PLE / 64) * (DM / 32);
    constexpr int NITEMS = 4 * I_GU + 2 * I_D + I_IN + 2 * I_SQ + I_PP;
    for (int it = gw; it < NITEMS; it += NGW) {
        int r = it;
        if (r < I_GU) { p0_item(P.w1g, DM, FF, P.g1pre, P.W1GU, MapGU{0}, scr, r, F.lane); continue; } r -= I_GU;
        if (r < I_GU) { p0_item(P.w1u, DM, FF, P.g1pre, P.W1GU, MapGU{1}, scr, r, F.lane); continue; } r -= I_GU;
        if (r < I_GU) { p0_item(P.w2g, DM, FF, P.g2pre, P.W2GU, MapGU{0}, scr, r, F.lane); continue; } r -= I_GU;
        if (r < I_GU) { p0_item(P.w2u, DM, FF, P.g2pre, P.W2GU, MapGU{1}, scr, r, F.lane); continue; } r -= I_GU;
        if (r < I_D) { p0_item(P.w1d, FF, DM, nullptr, P.W1D, MapPerm{}, scr, r, F.lane); continue; } r -= I_D;
        if (r < I_D) { p0_item(P.w2d, FF, DM, nullptr, P.W2D, MapPerm{}, scr, r, F.lane); continue; } r -= I_D;
        if (r < I_IN) { p0_item(P.win, DM, INW, P.gmpre, P.WIN, MapWin{}, scr, r, F.lane); continue; } r -= I_IN;
        if (r < I_SQ) { p0_item(P.wout, DM, DM, nullptr, P.WOUT, MapPerm{}, scr, r, F.lane); continue; } r -= I_SQ;
        if (r < I_SQ) { p0_item(P.wpg, DM, DM, nullptr, P.WPG, MapPerm{}, scr, r, F.lane); continue; } r -= I_SQ;
        p0_item(P.wpp, PLE, DM, nullptr, P.WPP, MapPerm{}, scr, r, F.lane);
    }
    for (int m = gw; m < M; m += NGW) {
        const GAS f32x4* xr = (const GAS f32x4*)(P.x + (size_t)m * DM);
        f32x4 v[2][2]; float s = 0.f;
#pragma unroll
        for (int j = 0; j < 2; ++j)
#pragma unroll
            for (int q = 0; q < 2; ++q) { v[j][q] = xr[2 * F.lane + 128 * j + q]; s += (v[j][q].x * v[j][q].x + v[j][q].y * v[j][q].y) + (v[j][q].z * v[j][q].z + v[j][q].w * v[j][q].w); }
        s = wave_sum(s);
        if (F.lane == 0) P.RS[m] = rsqrtf(s * (1.0f / DM) + RMS_EPS);
#pragma unroll
        for (int j = 0; j < 2; ++j) { v4u o; o.x = cvtpk(v[j][0].x, v[j][0].y); o.y = cvtpk(v[j][0].z, v[j][0].w); o.z = cvtpk(v[j][1].x, v[j][1].y); o.w = cvtpk(v[j][1].z, v[j][1].w);
            *(GAS v4u*)(P.XB + (size_t)m * DM + 8 * F.lane + 512 * j) = o; }
        const f32x4 pv = *(const GAS f32x4*)(P.p + (size_t)m * PLE + 4 * F.lane);
        unsigned long long pw = (unsigned long long)cvtpk(pv.x, pv.y) | ((unsigned long long)cvtpk(pv.z, pv.w) << 32);
        *(GAS unsigned long long*)(P.PB + (size_t)m * PLE + 4 * F.lane) = pw;
    }
}
template <bool WRITE_B, bool WRITE_RS>
__device__ __forceinline__ void norm_pass(Frame& F, const Ptrs& P, const float* res, const float* g, float alpha) {
    const int gw = F.vcu * NWAVES + F.wave, NGW = F.G * NWAVES;
    f32x4 gv[2][2];
#pragma unroll
    for (int j = 0; j < 2; ++j)
#pragma unroll
        for (int q = 0; q < 2; ++q) gv[j][q] = *(const GAS f32x4*)(g + 8 * F.lane + 512 * j + 4 * q) * alpha;
    for (int m = gw; m < M; m += NGW) {
        const float part = F.lane < 16 ? P.PS[(size_t)m * 16 + F.lane] : 0.f;
        v4u yw[2]; f32x4 rv[2][2];
#pragma unroll
        for (int j = 0; j < 2; ++j) { yw[j] = *(const GAS v4u*)(P.Y + (size_t)m * DM + 8 * F.lane + 512 * j);
#pragma unroll
            for (int q = 0; q < 2; ++q) rv[j][q] = *(const GAS f32x4*)(res + (size_t)m * DM + 8 * F.lane + 512 * j + 4 * q); }
        const float rstd = rsqrtf(wave_sum(part) * (1.0f / DM) + RMS_EPS);
        float s = 0.f;
#pragma unroll
        for (int j = 0; j < 2; ++j) {
            f32x4 y0 = {bflo(yw[j].x), bfhi(yw[j].x), bflo(yw[j].y), bfhi(yw[j].y)}, y1 = {bflo(yw[j].z), bfhi(yw[j].z), bflo(yw[j].w), bfhi(yw[j].w)};
            rv[j][0] = rv[j][0] + (y0 * rstd) * gv[j][0]; rv[j][1] = rv[j][1] + (y1 * rstd) * gv[j][1];
#pragma unroll
            for (int q = 0; q < 2; ++q) { *(GAS f32x4*)(P.out + (size_t)m * DM + 8 * F.lane + 512 * j + 4 * q) = rv[j][q];
                s += (rv[j][q].x * rv[j][q].x + rv[j][q].y * rv[j][q].y) + (rv[j][q].z * rv[j][q].z + rv[j][q].w * rv[j][q].w); }
            if (WRITE_B) { v4u o; o.x = cvtpk(rv[j][0].x, rv[j][0].y); o.y = cvtpk(rv[j][0].z, rv[j][0].w); o.z = cvtpk(rv[j][1].x, rv[j][1].y); o.w = cvtpk(rv[j][1].z, rv[j][1].w);
                *(GAS v4u*)(P.XB + (size_t)m * DM + 8 * F.lane + 512 * j) = o; }
        }
        if (WRITE_RS) { s = wave_sum(s); if (F.lane == 0) P.RS[m] = rsqrtf(s * (1.0f / DM) + RMS_EPS); }
    }
}

__device__ __forceinline__ void stage_rows(LAS unsigned char* dst, int lp, const bf16* src, int gp, int nrows, int cpr, int t, int nthr) {
    for (int i = t; i < nrows * cpr; i += nthr) { const int r = i / cpr, c = i - r * cpr;
        const v4u v = *(const GAS v4u*)(src + (size_t)r * gp + c * 8); *(LAS v4u*)(dst + r * lp + c * 16) = v; }
}
constexpr int KT_P = 192, VT_P = 320, KR_P = 144, V64_P = 192;
__device__ __forceinline__ void ret_kv_phase(Frame& F, const Ptrs& P) {
    const int half = F.wave >> 2, et = F.wave & 3, l = F.lane, hh = l >> 5;
    LAS unsigned char* reg = F.lds + RING_OFF + half * 65536;
    LAS unsigned char* Kimg = reg; LAS unsigned char* Vimg = reg + 128 * KT_P;
    const int lbK = ((l & 15) >> 2) * KT_P + (16 * ((l >> 4) & 1) + 4 * (l & 3)) * 2 + 8 * hh * KT_P;
    const int lbV = ((l & 15) >> 2) * VT_P + (16 * ((l >> 4) & 1) + 4 * (l & 3)) * 2 + 8 * hh * VT_P;
    for (int pi = F.vcu; pi < NUNIT_RET / 2; pi += F.G) {
        const int ui = 2 * pi + half, h = ui & 3, n = (ui >> 2) & 31, b = ui >> 7;
        const size_t row0 = (size_t)b * SEQ + (size_t)n * CH;
        const int t4 = F.tid & 255;
        stage_rows(Kimg, KT_P, P.Z + row0 * INW + 256 + 64 * h, INW, CH, 8, t4, 256);
        stage_rows(Vimg, VT_P, P.Z + row0 * INW + 512 + 128 * h, INW, CH, 16, t4, 256);
        LDS_WAIT(); __syncthreads();
        f32x16 acc[2]; acc[0] = f32x16{}; acc[1] = f32x16{};
#pragma unroll
        for (int ks = 0; ks < 8; ++ks) {
            const lds_cptr va = Vimg + lbV + (16 * ks) * VT_P + (32 * et) * 2;
            const bf16x8 A = cat8(vtr(va), vtr(va + 4 * VT_P));
#pragma unroll
            for (int dt = 0; dt < 2; ++dt) {
                const lds_cptr ka = Kimg + lbK + (16 * ks) * KT_P + (32 * dt) * 2;
                const bf16x8 Bf = cat8(vtr(ka), vtr(ka + 4 * KT_P));
                acc[dt] = __builtin_amdgcn_mfma_f32_32x32x16_bf16(A, Bf, acc[dt], 0, 0, 0);
            }
        }
        const float g127 = __builtin_amdgcn_exp2f(127.0f * pg8::log2_gamma(h));
        float* kv = P.KV + (size_t)ui * 8192;
#pragma unroll
        for (int dt = 0; dt < 2; ++dt)
#pragma unroll
            for (int r = 0; r < 16; ++r) kv[(32 * et + crow(r, hh)) * 64 + 32 * dt + (l & 31)] = acc[dt][r] * g127;
        LDS_WAIT(); __syncthreads();
    }
}
__device__ __forceinline__ void ret_scan_phase(Frame& F, const Ptrs& P) {
    const int total = BATCH * 4 * 4096;
    for (int idx = F.vcu * 512 + F.tid; idx < total; idx += F.G * 512) {
        const int bh = idx >> 12, ep = idx & 4095, b = bh >> 2, h = bh & 3;
        const float gC = __builtin_amdgcn_exp2f(128.0f * pg8::log2_gamma(h));
        float s0 = 0.f, s1 = 0.f;
#pragma unroll 8
        for (int n = 0; n < 32; ++n) {
            const size_t ui = (size_t)((b * 32 + n) * 4 + h);
            const f32x2v kv = *(const GAS f32x2v*)(P.KV + ui * 8192 + 2 * ep);
            *(GAS unsigned*)(P.ST + ui * 8192 + 2 * ep) = cvtpk(s0, s1);
            s0 = gC * s0 + kv.x; s1 = gC * s1 + kv.y;
        }
    }
}
__device__ __forceinline__ void ret_out_phase(Frame& F, const Ptrs& P) {
    const int half = F.wave >> 2, cb = F.wave & 3, l = F.lane, hh = l >> 5, c = l & 31;
    constexpr int REG = 128 * KR_P + 128 * VT_P;
    LAS unsigned char* reg = F.lds + RING_OFF + half * REG;
    LAS unsigned char* Kimg = reg; LAS unsigned char* Vimg = reg + 128 * KR_P;
    LAS unsigned char* stg = reg + cb * (32 * 272);
    const int lbV = ((l & 15) >> 2) * VT_P + (16 * ((l >> 4) & 1) + 4 * (l & 3)) * 2 + 4 * hh * VT_P;
    for (int pi = F.vcu; pi < NUNIT_RET / 2; pi += F.G) {
        const int ui = 2 * pi + half, h = ui & 3, n = (ui >> 2) & 31, b = ui >> 7;
        const size_t row0 = (size_t)b * SEQ + (size_t)n * CH;
        const int t4 = F.tid & 255;
        stage_rows(Kimg, KR_P, P.Z + row0 * INW + 256 + 64 * h, INW, CH, 8, t4, 256);
        stage_rows(Vimg, VT_P, P.Z + row0 * INW + 512 + 128 * h, INW, CH, 16, t4, 256);
        bf16x8 qb[4];
#pragma unroll
        for (int ks = 0; ks < 4; ++ks) qb[ks] = *(const GAS bf16x8*)(P.Z + (row0 + 32 * cb + c) * INW + 64 * h + 16 * ks + 8 * hh);
        f32x16 acc[4];
#pragma unroll
        for (int et = 0; et < 4; ++et) acc[et] = f32x16{};
        const bf16* st = P.ST + (size_t)ui * 8192;
#pragma unroll
        for (int et = 0; et < 4; ++et)
#pragma unroll
            for (int ks = 0; ks < 4; ++ks) {
                const bf16x8 a = *(const GAS bf16x8*)(st + (32 * et + c) * 64 + 16 * ks + 8 * hh);
                acc[et] = __builtin_amdgcn_mfma_f32_32x32x16_bf16(a, qb[ks], acc[et], 0, 0, 0);
            }
        const float gam = __builtin_amdgcn_exp2f(pg8::log2_gamma(h));
#pragma unroll
        for (int et = 0; et < 4; ++et) acc[et] = acc[et] * gam;
        LDS_WAIT(); __syncthreads();
        for (int mb = 0; mb <= cb; ++mb) {
            f32x16 s = f32x16{};
#pragma unroll
            for (int ks = 0; ks < 4; ++ks) {
                const bf16x8 kf = *(const LAS bf16x8*)(Kimg + (32 * mb + c) * KR_P + (16 * ks + 8 * hh) * 2);
                s = __builtin_amdgcn_mfma_f32_32x32x16_bf16(kf, qb[ks], s, 0, 0, 0);
            }
            if (mb == cb) {
#pragma unroll
                for (int r = 0; r < 16; ++r) if (crow(r, hh) > c) s[r] = 0.f;
            }
#pragma unroll
            for (int s2 = 0; s2 < 2; ++s2) {
                v4u pw; pw.x = cvtpk(s[8 * s2 + 0], s[8 * s2 + 1]); pw.y = cvtpk(s[8 * s2 + 2], s[8 * s2 + 3]); pw.z = cvtpk(s[8 * s2 + 4], s[8 * s2 + 5]); pw.w = cvtpk(s[8 * s2 + 6], s[8 * s2 + 7]);
                const bf16x8 pf = __builtin_bit_cast(bf16x8, pw);
#pragma unroll
                for (int et = 0; et < 4; ++et) {
                    const lds_cptr va = Vimg + lbV + (32 * mb + 16 * s2) * VT_P + (32 * et) * 2;
                    const bf16x8 vf = cat8(vtr(va), vtr(va + 8 * VT_P));
                    acc[et] = __builtin_amdgcn_mfma_f32_32x32x16_bf16(vf, pf, acc[et], 0, 0, 0);
                }
            }
        }
        float s1 = 0.f;
#pragma unroll
        for (int et = 0; et < 4; ++et)
#pragma unroll
            for (int r = 0; r < 16; ++r) s1 += acc[et][r];
        s1 += __shfl_xor(s1, 32);
        const float mu = s1 * (1.0f / 128.0f);
        float s2v = 0.f;
#pragma unroll
        for (int et = 0; et < 4; ++et)
#pragma unroll
            for (int r = 0; r < 16; ++r) { const float d = acc[et][r] - mu; acc[et][r] = d; s2v += d * d; }
        s2v += __shfl_xor(s2v, 32);
        const float rstd = rsqrtf(s2v * (1.0f / 128.0f) + RMS_EPS);
        LDS_WAIT(); __syncthreads();
#pragma unroll
        for (int et = 0; et < 4; ++et)
#pragma unroll
            for (int g = 0; g < 4; ++g) {
                const unsigned long long w = (unsigned long long)cvtpk(acc[et][4 * g] * rstd, acc[et][4 * g + 1] * rstd) | ((unsigned long long)cvtpk(acc[et][4 * g + 2] * rstd, acc[et][4 * g + 3] * rstd) << 32);
                *(LAS unsigned long long*)(stg + c * 272 + (32 * et + 8 * g + 4 * hh) * 2) = w;
            }
        LDS_WAIT();
#pragma unroll
        for (int it = 0; it < 8; ++it) {
            const int idx = it * 64 + l, rr = idx >> 4, chn = idx & 15;
            const v4u y = *(const LAS v4u*)(stg + rr * 272 + chn * 16);
            const size_t row = row0 + 32 * cb + rr;
            const v4u gt = *(const GAS v4u*)(P.Z + row * INW + 1024 + 128 * h + chn * 8);
            v4u o; o.x = cvtpk(bflo(y.x) * bflo(gt.x), bfhi(y.x) * bfhi(gt.x)); o.y = cvtpk(bflo(y.y) * bflo(gt.y), bfhi(y.y) * bfhi(gt.y));
            o.z = cvtpk(bflo(y.z) * bflo(gt.z), bfhi(y.z) * bfhi(gt.z)); o.w = cvtpk(bflo(y.w) * bflo(gt.w), bfhi(y.w) * bfhi(gt.w));
            *(GAS v4u*)(P.XB + row * DM + 128 * h + chn * 8) = o;
        }
        LDS_WAIT(); __syncthreads();
    }
}
__device__ __forceinline__ void swa_phase(Frame& F, const Ptrs& P) {
    const int l = F.lane, hh = l >> 5, c = l & 31;
    LAS unsigned char* Kimg = F.lds + RING_OFF; LAS unsigned char* Vimg = Kimg + 256 * KR_P;
    LAS unsigned char* stg = Vimg + 256 * V64_P + F.wave * (32 * 144);
    const int lbV = ((l & 15) >> 2) * V64_P + (16 * ((l >> 4) & 1) + 4 * (l & 3)) * 2 + 4 * hh * V64_P;
    constexpr int NU = BATCH * 32 * 2;
    for (int ui = F.vcu; ui < NU; ui += F.G) {
        const int kvh = ui & 1, n = (ui >> 1) & 31, b = ui >> 6;
        const size_t row0 = (size_t)b * SEQ + (size_t)n * CH;
        const int jlo = n == 0 ? 128 : 0;
        stage_rows(Kimg + jlo * KR_P, KR_P, P.Z + (row0 - 128 + jlo) * INW + 2048 + 64 * kvh, INW, 256 - jlo, 8, F.tid, 512);
        stage_rows(Vimg + jlo * V64_P, V64_P, P.Z + (row0 - 128 + jlo) * INW + 2176 + 64 * kvh, INW, 256 - jlo, 8, F.tid, 512);
        const int hq = 4 * kvh + (F.wave >> 1);
        const float sink2 = P.sinks[hq] * 1.4426950408889634f;
        LDS_WAIT(); __syncthreads();
#pragma unroll 1
        for (int t2 = 0; t2 < 2; ++t2) {
            const int qsb = 2 * (F.wave & 1) + t2;
            bf16x8 qb[4];
#pragma unroll
            for (int ks = 0; ks < 4; ++ks) qb[ks] = *(const GAS bf16x8*)(P.Z + (row0 + 32 * qsb + c) * INW + 1536 + 64 * hq + 16 * ks + 8 * hh);
            f32x16 S[5];
#pragma unroll
            for (int t = 0; t < 5; ++t) {
                const int kb = qsb + t;
                S[t] = f32x16{};
                if (n == 0 && kb < 4) {
#pragma unroll
                    for (int r = 0; r < 16; ++r) S[t][r] = -1e30f;
                } else {
#pragma unroll
                    for (int ks = 0; ks < 4; ++ks) {
                        const bf16x8 kf = *(const LAS bf16x8*)(Kimg + (32 * kb + c) * KR_P + (16 * ks + 8 * hh) * 2);
                        S[t] = __builtin_amdgcn_mfma_f32_32x32x16_bf16(kf, qb[ks], S[t], 0, 0, 0);
                    }
                    if (t == 0) {
#pragma unroll
                        for (int r = 0; r < 16; ++r) if (!(crow(r, hh) > c)) S[t][r] = -1e30f;
                    }
                    if (t == 4) {
#pragma unroll
                        for (int r = 0; r < 16; ++r) if (!(crow(r, hh) <= c)) S[t][r] = -1e30f;
                    }
                }
            }
            float mx = sink2;
#pragma unroll
            for (int t = 0; t < 5; ++t)
#pragma unroll
                for (int r = 0; r < 16; ++r) mx = fmaxf(mx, S[t][r]);
            mx = fmaxf(mx, __shfl_xor(mx, 32));
            float sum = 0.f;
#pragma unroll
            for (int t = 0; t < 5; ++t)
#pragma unroll
                for (int r = 0; r < 16; ++r) { const float e = __builtin_amdgcn_exp2f(S[t][r] - mx); S[t][r] = e; sum += e; }
            sum += __shfl_xor(sum, 32);
            const float inv = __builtin_amdgcn_rcpf(sum + __builtin_amdgcn_exp2f(sink2 - mx));
            f32x16 o[2]; o[0] = f32x16{}; o[1] = f32x16{};
#pragma unroll
            for (int t = 0; t < 5; ++t) {
                const int kb = qsb + t;
                if (!(n == 0 && kb < 4)) {
#pragma unroll
                    for (int s2 = 0; s2 < 2; ++s2) {
                        v4u pw; pw.x = cvtpk(S[t][8 * s2 + 0], S[t][8 * s2 + 1]); pw.y = cvtpk(S[t][8 * s2 + 2], S[t][8 * s2 + 3]); pw.z = cvtpk(S[t][8 * s2 + 4], S[t][8 * s2 + 5]); pw.w = cvtpk(S[t][8 * s2 + 6], S[t][8 * s2 + 7]);
                        const bf16x8 pf = __builtin_bit_cast(bf16x8, pw);
#pragma unroll
                        for (int dt = 0; dt < 2; ++dt) {
                            const lds_cptr va = Vimg + lbV + (32 * kb + 16 * s2) * V64_P + (32 * dt) * 2;
                            const bf16x8 vf = cat8(vtr(va), vtr(va + 8 * V64_P));
                            o[dt] = __builtin_amdgcn_mfma_f32_32x32x16_bf16(vf, pf, o[dt], 0, 0, 0);
                        }
                    }
                }
            }
#pragma unroll
            for (int dt = 0; dt < 2; ++dt)
#pragma unroll
                for (int g = 0; g < 4; ++g) {
                    const unsigned long long w = (unsigned long long)cvtpk(o[dt][4 * g] * inv, o[dt][4 * g + 1] * inv) | ((unsigned long long)cvtpk(o[dt][4 * g + 2] * inv, o[dt][4 * g + 3] * inv) << 32);
                    *(LAS unsigned long long*)(stg + c * 144 + (32 * dt + 8 * g + 4 * hh) * 2) = w;
                }
            LDS_WAIT();
#pragma unroll
            for (int it = 0; it < 4; ++it) {
                const int idx = it * 64 + l, rr = idx >> 3, chn = idx & 7;
                const v4u y = *(const LAS v4u*)(stg + rr * 144 + chn * 16);
                *(GAS v4u*)(P.XB + (row0 + 32 * qsb + rr) * DM + 512 + 64 * hq + chn * 8) = y;
            }
            LDS_WAIT();
        }
        __syncthreads();
    }
}
#ifndef MK_PER_PHASE
#define MK_PER_PHASE 0
#endif
constexpr int N_PHASES = 16;
struct Args { const void* in[22]; float* out; unsigned char* ws; int ph_lo, ph_hi; };
__global__ void __launch_bounds__(NWAVES * 64, 2) mega_fwd(Args args) {
    extern __shared__ __attribute__((aligned(16))) unsigned char lds[];
    Frame F;
    F.lds = (LAS unsigned char*)lds;
    F.MISC = (volatile LAS unsigned*)(F.lds + MISC_OFF);
    F.tid = threadIdx.x; F.lane = F.tid & 63; F.wave = __builtin_amdgcn_readfirstlane(F.tid >> 6);
    F.G = gridDim.x; { const int bx = blockIdx.x; F.vcu = (F.G % 8 == 0) ? (bx % 8) * (F.G / 8) + bx / 8 : bx; }
    unsigned char* ws = args.ws;
    F.ctl = (gu32*)(ws + WS_CTL);
    Ptrs P;
    P.x = (const float*)args.in[0]; P.p = (const float*)args.in[1]; P.pos = (const int*)args.in[2];
    P.g1pre = (const float*)args.in[3]; P.g1post = (const float*)args.in[4]; P.w1g = (const float*)args.in[5]; P.w1u = (const float*)args.in[6]; P.w1d = (const float*)args.in[7];
    P.gmpre = (const float*)args.in[8]; P.gmpost = (const float*)args.in[9]; P.win = (const float*)args.in[10]; P.bin = (const float*)args.in[11]; P.sinks = (const float*)args.in[12]; P.wout = (const float*)args.in[13];
    P.g2pre = (const float*)args.in[14]; P.g2post = (const float*)args.in[15]; P.w2g = (const float*)args.in[16]; P.w2u = (const float*)args.in[17]; P.w2d = (const float*)args.in[18];
    P.wpp = (const float*)args.in[19]; P.wpg = (const float*)args.in[20]; P.gple = (const float*)args.in[21];
    P.out = args.out;
    P.W1GU = (bf16*)(ws + WS_W1GU); P.W1D = (bf16*)(ws + WS_W1D); P.WIN = (bf16*)(ws + WS_WIN); P.WOUT = (bf16*)(ws + WS_WOUT); P.W2GU = (bf16*)(ws + WS_W2GU); P.W2D = (bf16*)(ws + WS_W2D);
    P.WPG = (bf16*)(ws + WS_WPG); P.WPP = (bf16*)(ws + WS_WPP); P.PB = (bf16*)(ws + WS_PB); P.XB = (bf16*)(ws + WS_XB); P.Y = (bf16*)(ws + WS_Y); P.H = (bf16*)(ws + WS_H); P.Z = (bf16*)(ws + WS_H);
    P.PP = (bf16*)(ws + WS_H); P.ST = (bf16*)(ws + WS_ST); P.RS = (float*)(ws + WS_RS); P.PS = (float*)(ws + WS_PS); P.KV = (float*)(ws + WS_KV);
    for (int u = F.tid; u < (LDS_BYTES - LDSCTL_OFF) / 4; u += NWAVES * 64) ((LAS unsigned*)(F.lds + LDSCTL_OFF))[u] = 0u;
    __syncthreads();
    XcdBarrier bar; bar.bar = (unsigned*)(F.ctl + 4096); bar.x = 0; bar.st = nullptr;
    if (!MK_PER_PHASE) bar = xcd_barrier_post((unsigned*)(F.ctl + 4096), F.MISC + 8);
    const int lo = args.ph_lo, hi = args.ph_hi;
#ifndef PHASE_MASK
#define PHASE_MASK 0xffff
#endif
#define IN(k) (((PHASE_MASK >> (k)) & 1) && lo <= (k) && (k) < hi)
#define SEAM(k) do { if (IN(k) && IN((k) + 1)) xcd_barrier(bar); } while (0)
    const int cblk = (int)blockIdx.x;

    if (IN(0)) { p0_prologue(F, P); } SEAM(0);
    if (IN(1)) { pg8::Gemm g{P.XB, P.W1GU, M, 2 * FF, DM}; pg8::StaticOrder S; S.init(M, 2 * FF, F.G, cblk); pg8::EpiGateUp E{P.H, P.RS, FF};
        pg8::gemm_phase<pg8::EpiGateUp, pg8::StaticOrder, true, true>(F.lds + RING_OFF, g, S, E); } SEAM(1);
    if (IN(2)) { pg8::Gemm g{P.H, P.W1D, M, DM, FF}; pg8::StaticOrder S; S.init(M, DM, F.G, cblk); pg8::EpiStats<0> E{P.Y, P.PS, nullptr, DM};
        pg8::gemm_phase<pg8::EpiStats<0>, pg8::StaticOrder, true, true>(F.lds + RING_OFF, g, S, E); } SEAM(2);
    if (IN(3)) { norm_pass<true, true>(F, P, P.x, P.g1post, 0.5f); } SEAM(3);
    if (IN(4)) { pg8::Gemm g{P.XB, P.WIN, M, INW, DM}; pg8::StaticOrder S; S.init(M, INW, F.G, cblk); pg8::EpiWin E{P.Z, P.RS, P.bin, P.pos, INW};
        pg8::gemm_phase<pg8::EpiWin, pg8::StaticOrder, true, true>(F.lds + RING_OFF, g, S, E); } SEAM(4);
    if (IN(5)) { ret_kv_phase(F, P); swa_phase(F, P); } SEAM(5);
    if (IN(6)) { ret_scan_phase(F, P); } SEAM(6);
    if (IN(7)) { ret_out_phase(F, P); } SEAM(7);
    if (IN(8)) { pg8::Gemm g{P.XB, P.WOUT, M, DM, DM}; pg8::StaticOrder S; S.init(M, DM, F.G, cblk); pg8::EpiStats<0> E{P.Y, P.PS, nullptr, DM};
        pg8::gemm_phase<pg8::EpiStats<0>, pg8::StaticOrder, true, true>(F.lds + RING_OFF, g, S, E); } SEAM(8);
    if (IN(9)) { norm_pass<true, true>(F, P, P.out, P.gmpost, 1.0f); } SEAM(9);
    if (IN(10)) { pg8::Gemm g{P.XB, P.W2GU, M, 2 * FF, DM}; pg8::StaticOrder S; S.init(M, 2 * FF, F.G, cblk); pg8::EpiGateUp E{P.H, P.RS, FF};
        pg8::gemm_phase<pg8::EpiGateUp, pg8::StaticOrder, true, true>(F.lds + RING_OFF, g, S, E); } SEAM(10);
    if (IN(11)) { pg8::Gemm g{P.H, P.W2D, M, DM, FF}; pg8::StaticOrder S; S.init(M, DM, F.G, cblk); pg8::EpiStats<0> E{P.Y, P.PS, nullptr, DM};
        pg8::gemm_phase<pg8::EpiStats<0>, pg8::StaticOrder, true, true>(F.lds + RING_OFF, g, S, E); } SEAM(11);
    if (IN(12)) { norm_pass<true, false>(F, P, P.out, P.g2post, 0.5f); } SEAM(12);
    if (IN(13)) { int kpp = PLE; asm volatile("" : "+s"(kpp)); pg8::Gemm g{P.PB, P.WPP, M, DM, kpp}; pg8::StaticOrder S; S.init(M, DM, F.G, cblk); pg8::EpiPlain E{P.PP, DM};
        pg8::gemm_phase<pg8::EpiPlain, pg8::StaticOrder, true, true>(F.lds + RING_OFF, g, S, E); } SEAM(13);
    if (IN(14)) { pg8::Gemm g{P.XB, P.WPG, M, DM, DM}; pg8::StaticOrder S; S.init(M, DM, F.G, cblk); pg8::EpiStats<1> E{P.Y, P.PS, P.PP, DM};
        pg8::gemm_phase<pg8::EpiStats<1>, pg8::StaticOrder, true, true>(F.lds + RING_OFF, g, S, E); } SEAM(14);
    if (IN(15)) { norm_pass<false, false>(F, P, P.out, P.gple, 1.0f); }
#undef IN
#undef SEAM
}

static int g_grid = 0;
static void launch_fast(void* const* d_in, float* out, void* d_ws, hipStream_t stream) {
    if (g_grid == 0) {
        int dev = 0, cus = 0;
        if (hipGetDevice(&dev) != hipSuccess || hipDeviceGetAttribute(&cus, hipDeviceAttributeMultiprocessorCount, dev) != hipSuccess) { fprintf(stderr, "kernel_launch: device query failed\n"); g_grid = -1; return; }
        if (hipFuncSetAttribute((const void*)mega_fwd, hipFuncAttributeMaxDynamicSharedMemorySize, LDS_BYTES) != hipSuccess) { fprintf(stderr, "kernel_launch: hipFuncSetAttribute failed\n"); g_grid = -1; return; }
        int per_cu = 0;
        if (hipOccupancyMaxActiveBlocksPerMultiprocessor(&per_cu, (const void*)mega_fwd, NWAVES * 64, LDS_BYTES) != hipSuccess || per_cu < 1) fprintf(stderr, "kernel_launch: occupancy query says %d\n", per_cu);
        (void)hipGetLastError();
        g_grid = cus;
    }
    if (g_grid < 0) return;
    (void)hipMemsetAsync((char*)d_ws + WS_CTL, 0, CTL_ZERO_BYTES, stream);
    Args a{};
    for (int i = 0; i < 22; ++i) a.in[i] = d_in[i];
    a.out = out; a.ws = (unsigned char*)d_ws;
#if MK_PER_PHASE
    for (int ph = 0; ph < N_PHASES; ++ph) { a.ph_lo = ph; a.ph_hi = ph + 1; hipLaunchKernelGGL(mega_fwd, dim3(g_grid), dim3(NWAVES * 64), LDS_BYTES, stream, a); }
#else
    a.ph_lo = 0; a.ph_hi = N_PHASES;
    hipLaunchKernelGGL(mega_fwd, dim3(g_grid), dim3(NWAVES * 64), LDS_BYTES, stream, a);
#endif
}
extern "C" void kernel_launch(void* const* d_in, const int* in_sizes, int n_in, void* d_out, int out_size, void* d_ws, size_t ws_size, hipStream_t stream) {
    launch_fast(d_in, (float*)d_out, d_ws, stream);
}
```
